# Optimizing an MI355X kernel written in HIP

```python
import jax, jax.numpy as jnp
from jax import lax
import numpy as np

D_MODEL = 1024
BATCH = 2
SEQ = 8192
DEPTH = 2
DEC_BATCH = 16
DEC_SEQ = 2048
PAST_LEN = 128

N_MIXERS = 2
CONV_WIDTH = 3
MLSTM_HEADS = 8
QK_DIM = D_MODEL // (2 * MLSTM_HEADS)
V_DIM = D_MODEL // MLSTM_HEADS
QK_W = MLSTM_HEADS * QK_DIM
MLSTM_PROJ = 2 * QK_W + 2 * D_MODEL + 4 * MLSTM_HEADS
CHUNK = 128
D_FF = -(-8 * D_MODEL // (3 * 256)) * 256
EPS = 1e-6

kernel_name = "hybrid_conv_mlstm_bidir_encoder"


def rms_norm(x, g):
    xf = x.astype(jnp.float32)
    y = xf * lax.rsqrt(jnp.mean(xf * xf, axis=-1, keepdims=True) + EPS)
    return (y * g.astype(jnp.float32)).astype(x.dtype)


def short_conv_mixer(x, w_in, conv_w, w_out):
    S = x.shape[1]
    b, c, v = jnp.split(x @ w_in, 3, axis=-1)
    u = c * v
    pad = CONV_WIDTH // 2
    up = jnp.pad(u, ((0, 0), (pad, pad), (0, 0)))
    conv = sum(up[:, j:j + S] * conv_w[j] for j in range(CONV_WIDTH))
    return (b * conv) @ w_out


def mlstm_chunkwise(q, k, v, log_i, log_f):
    Bn, H, S, dk = q.shape
    dv = v.shape[-1]
    nc = S // CHUNK

    def to_chunks(a):
        return jnp.moveaxis(a.reshape((Bn, H, nc, CHUNK) + a.shape[3:]), 2, 0)

    xs = tuple(map(to_chunks, (q, k, v, log_i, log_f)))
    lower = jnp.tril(jnp.ones((CHUNK, CHUNK), dtype=bool))

    def step(carry, xs_c):
        C, n, m = carry
        qb, kb, vb, ib, fb = xs_c
        bcum = jnp.cumsum(fb, axis=-1)
        dmat = bcum[..., :, None] - bcum[..., None, :] + ib[..., None, :]
        dmat = jnp.where(lower, dmat, -jnp.inf)
        m_inter = bcum + m[..., None]
        m_t = jnp.maximum(m_inter, jnp.max(dmat, axis=-1))
        w_intra = jnp.exp(dmat - m_t[..., None])
        w_inter = jnp.exp(m_inter - m_t)
        scores = jnp.einsum('bhtd,bhsd->bhts', qb, kb) * w_intra
        num = (jnp.einsum('bhts,bhsv->bhtv', scores, vb)
               + w_inter[..., None] * jnp.einsum('bhtd,bhdv->bhtv', qb, C))
        den = jnp.sum(scores, axis=-1) + w_inter * jnp.einsum('bhtd,bhd->bht', qb, n)
        h = num / jnp.maximum(jnp.abs(den), jnp.exp(-m_t))[..., None]
        b_last = bcum[..., -1]
        d_last = b_last[..., None] - bcum + ib
        m_new = jnp.maximum(b_last + m, jnp.max(d_last, axis=-1))
        w_s = jnp.exp(d_last - m_new[..., None])
        decay = jnp.exp(b_last + m - m_new)
        C_new = decay[..., None, None] * C + jnp.einsum('bhs,bhsd,bhsv->bhdv', w_s, kb, vb)
        n_new = decay[..., None] * n + jnp.einsum('bhs,bhsd->bhd', w_s, kb)
        return (C_new, n_new, m_new), h

    init = (jnp.zeros((Bn, H, dk, dv), jnp.float32),
            jnp.zeros((Bn, H, dk), jnp.float32),
            jnp.zeros((Bn, H), jnp.float32))
    _, hs = lax.scan(step, init, xs)
    return jnp.moveaxis(hs, 0, 2).reshape(Bn, H, S, dv)


def mlstm_mixer(x, w_in, b_gate, norm_g, w_out):
    Bn, S, _ = x.shape
    H = MLSTM_HEADS
    proj = x @ w_in
    q, k, v, o, gates = jnp.split(
        proj, [QK_W, 2 * QK_W, 2 * QK_W + D_MODEL, 2 * QK_W + 2 * D_MODEL], axis=-1)

    def heads(a, d):
        return a.reshape(Bn, S, H, d).transpose(0, 2, 1, 3).astype(jnp.float32)

    qh = heads(q, QK_DIM) * (QK_DIM ** -0.5)
    kh = heads(k, QK_DIM)
    vh = heads(v, V_DIM)
    g = (gates.astype(jnp.float32) + b_gate.astype(jnp.float32)).transpose(0, 2, 1)
    i_f, f_f, i_b, f_b = jnp.split(g, 4, axis=1)
    h_fwd = mlstm_chunkwise(qh, kh, vh, i_f, jax.nn.log_sigmoid(f_f))
    flip = lambda a: jnp.flip(a, axis=2)
    h_bwd = flip(mlstm_chunkwise(flip(qh), flip(kh), flip(vh), flip(i_b),
                                 flip(jax.nn.log_sigmoid(f_b))))
    h = h_fwd + h_bwd
    h = h * lax.rsqrt(jnp.mean(h * h, axis=-1, keepdims=True) + EPS)
    h = h.transpose(0, 2, 1, 3).reshape(Bn, S, D_MODEL) * norm_g.astype(jnp.float32)
    h = (jax.nn.sigmoid(o.astype(jnp.float32)) * h).astype(x.dtype)
    return h @ w_out


def swiglu(x, w_in, w_out):
    gate, up = jnp.split(x @ w_in, 2, axis=-1)
    return (jax.nn.silu(gate) * up) @ w_out


def trunk(x, norms, conv_w_in, conv_w, conv_w_out,
          mlstm_w_in, mlstm_b_gate, mlstm_norm, mlstm_w_out, ffn_w_in, ffn_w_out):
    for i in range(DEPTH):
        j = i // N_MIXERS
        h = rms_norm(x, norms[i, 0])
        if i % N_MIXERS == 0:
            mix = short_conv_mixer(h, conv_w_in[j], conv_w[j], conv_w_out[j])
        else:
            mix = mlstm_mixer(h, mlstm_w_in[j], mlstm_b_gate[j], mlstm_norm[j], mlstm_w_out[j])
        x = x + rms_norm(mix, norms[i, 1])
        h = rms_norm(x, norms[i, 2])
        x = x + rms_norm(swiglu(h, ffn_w_in[i], ffn_w_out[i]), norms[i, 3])
    return x


def setup_inputs(seed: int = 0) -> dict:
    key = jax.random.key(seed)
    ks = jax.random.split(key, 16)
    n_conv = (DEPTH + N_MIXERS - 1) // N_MIXERS
    n_ml = DEPTH // N_MIXERS
    H = MLSTM_HEADS
    nrm = lambda k, s, scale: jax.random.normal(k, s, jnp.float32) * scale
    gb = jax.random.normal(ks[7], (n_ml, 4 * H), jnp.float32)
    gate_offset = jnp.concatenate([jnp.zeros((H,)), 3.0 * jnp.ones((H,)),
                                   jnp.zeros((H,)), 3.0 * jnp.ones((H,))]).astype(jnp.float32)
    return {
        "x_prompt": nrm(ks[0], (BATCH, SEQ, D_MODEL), 1.0),
        "x_sample": nrm(ks[1], (DEC_BATCH, DEC_SEQ, D_MODEL), 1.0),
        "norms": 1.0 + nrm(ks[2], (DEPTH, 4, D_MODEL), 0.05),
        "conv_w_in": nrm(ks[3], (n_conv, D_MODEL, 3 * D_MODEL), D_MODEL ** -0.5),
        "conv_w": nrm(ks[4], (n_conv, CONV_WIDTH, D_MODEL), CONV_WIDTH ** -0.5),
        "conv_w_out": nrm(ks[5], (n_conv, D_MODEL, D_MODEL), D_MODEL ** -0.5),
        "mlstm_w_in": nrm(ks[6], (n_ml, D_MODEL, MLSTM_PROJ), D_MODEL ** -0.5),
        "mlstm_b_gate": gate_offset + 0.3 * gb,
        "mlstm_norm": 1.0 + nrm(ks[8], (n_ml, D_MODEL), 0.05),
        "mlstm_w_out": nrm(ks[9], (n_ml, D_MODEL, D_MODEL), D_MODEL ** -0.5),
        "ffn_w_in": nrm(ks[10], (DEPTH, D_MODEL, 2 * D_FF), D_MODEL ** -0.5),
        "ffn_w_out": nrm(ks[11], (DEPTH, D_FF, D_MODEL), D_FF ** -0.5),
    }


def reference(x_prompt, x_sample, norms, conv_w_in, conv_w, conv_w_out,
              mlstm_w_in, mlstm_b_gate, mlstm_norm, mlstm_w_out, ffn_w_in, ffn_w_out):
    y_prompt = trunk(x_prompt, norms, conv_w_in, conv_w, conv_w_out,
                     mlstm_w_in, mlstm_b_gate, mlstm_norm, mlstm_w_out, ffn_w_in, ffn_w_out)
    y_sample = trunk(x_sample, norms, conv_w_in, conv_w, conv_w_out,
                     mlstm_w_in, mlstm_b_gate, mlstm_norm, mlstm_w_out, ffn_w_in, ffn_w_out)
    return (y_prompt, y_sample)
```

```cpp
#include <hip/hip_runtime.h>
#include <hip/hip_cooperative_groups.h>
#include <cstdio>
#include <cstdint>
namespace cg = cooperative_groups;


#ifndef MK_ONE_LAUNCH
#define MK_ONE_LAUNCH 1
#endif

#define LAS __attribute__((address_space(3)))
typedef unsigned short bf16_t;
typedef short bf16x8 __attribute__((ext_vector_type(8)));
typedef short s16x4 __attribute__((ext_vector_type(4)));
typedef float f32x4 __attribute__((ext_vector_type(4)));
typedef float f32x2 __attribute__((ext_vector_type(2)));
typedef unsigned u32x4 __attribute__((ext_vector_type(4)));
typedef unsigned u32x2 __attribute__((ext_vector_type(2)));

constexpr int DM = 1024, TP = 16384, TSM = 32768, T = TP + TSM, SEQ_P = 8192, SEQ_S = 2048;
constexpr int NPROJ = 3072, NML = 3328, DFF = 2816, NFF = 2 * DFF;
constexpr int NCHUNK = T / 128, NITEM = NCHUNK * 8, NID = NITEM * 2;
constexpr float EPS = 1e-6f;
constexpr size_t MiB = 1u << 20;
constexpr size_t WS_W_CIN = 1 * MiB, WS_W_COUT = 7 * MiB, WS_W_MLIN = 9 * MiB, WS_W_MLOUT = 16 * MiB, WS_W_FIN0 = 18 * MiB, WS_W_FIN1 = 29 * MiB,
                 WS_W_FOUT0 = 40 * MiB, WS_W_FOUT1 = 46 * MiB;
constexpr size_t WS_GATES = 52 * MiB, WS_NST = 58 * MiB, WS_MLOC = 60 * MiB, WS_BLAST = 60 * MiB + 32768, WS_MST = 60 * MiB + 65536;
constexpr size_t WS_XN = 64 * MiB, WS_BIG = 160 * MiB, WS_END = 448 * MiB;
constexpr int LDS_BYTES = 147456;

typedef __bf16 bf16x2_t __attribute__((ext_vector_type(2)));
__device__ __forceinline__ unsigned cvt_pk_bf16(float lo, float hi) { f32x2 v = {lo, hi}; bf16x2_t r = __builtin_convertvector(v, bf16x2_t); return __builtin_bit_cast(unsigned, r); }
__device__ __forceinline__ float bf2f(unsigned short b) { return __uint_as_float(((unsigned)b) << 16); }
__device__ __forceinline__ float bflo(unsigned w) { return __uint_as_float(w << 16); }
__device__ __forceinline__ float bfhi(unsigned w) { return __uint_as_float(w & 0xffff0000u); }

namespace pg8 {
constexpr int BM = 256, BK = 64, HALF = 128, HTB = HALF * BK * 2, STAGE_BYTES = 8 * HTB, NXCD = 8, WGM = 8;
__host__ __device__ __forceinline__ int lds_byte(int r, int c) { const int st = (r >> 4) * 2 + (c >> 5), rr = r & 15, cc = c & 31, ob = rr * 64 + cc * 2; return st * 1024 + (ob ^ (((ob >> 9) & 1) << 5)); }
__host__ __device__ __forceinline__ void stage_rc(int b, int& R, int& C) { const int st = b / 1024, sb = b % 1024, swz = sb ^ (((sb >> 9) & 1) << 5); R = (st >> 1) * 16 + swz / 64; C = (st & 1) * 32 + (swz % 64) / 2; }
__host__ __device__ __forceinline__ int perm32(int rho) { const int n = rho >> 4, i = rho & 15; return 8 * (i >> 2) + 4 * n + (i & 3); }

struct Unit { int pm, pn; };
struct Gemm { const bf16_t* A; const bf16_t* Bt; int lda, M, N, K; };

struct StaticOrder {
    int nM, nN, nwg, G, c;
    __host__ __device__ void init(int M, int N, int G_, int c_) { nM = M / BM; nN = N / BM; nwg = nM * nN; G = G_; c = c_; }
    __host__ __device__ bool next(int i, Unit& u) const {
        const long L = (long)i * G + c; if (L >= nwg) return false;
        int wgid = (int)L; { const int q = nwg / NXCD, r = nwg % NXCD, xcd = wgid % NXCD, off = wgid / NXCD; wgid = (xcd < r ? xcd * (q + 1) : r * (q + 1) + (xcd - r) * q) + off; }
        const int nig = WGM * nN, gid = wgid / nig, fm = gid * WGM, gsz = (nM - fm) < WGM ? (nM - fm) : WGM;
        u.pm = fm + ((wgid % nig) % gsz); u.pn = (wgid % nig) / gsz; return true;
    }
};

struct EpiBf16 {
    static constexpr bool PERM = true;
    bf16_t* O; int ldc; int scale_cols; float scale0;
    __device__ __forceinline__ void operator()(const f32x4 (&acc)[2][2][4][2], const Unit& u, int wr, int wc, int fr, int fq) const {
        const int row0 = u.pm * BM + wr * 64 + fr; const int colt = u.pn * BM;
        const float sc = (colt < scale_cols) ? scale0 : 1.f;
        const int col0 = colt + wc * 32 + 8 * fq;
#pragma unroll
        for (int ai = 0; ai < 2; ++ai)
#pragma unroll
            for (int m = 0; m < 4; ++m) { bf16_t* rowp = O + (size_t)(row0 + ai * HALF + m * 16) * ldc + col0;
#pragma unroll
                for (int bj = 0; bj < 2; ++bj) { const f32x4 v0 = acc[ai][bj][m][0] * sc, v1 = acc[ai][bj][m][1] * sc;
                    u32x4 w; w.x = cvt_pk_bf16(v0[0], v0[1]); w.y = cvt_pk_bf16(v0[2], v0[3]); w.z = cvt_pk_bf16(v1[0], v1[1]); w.w = cvt_pk_bf16(v1[2], v1[3]);
                    *(u32x4*)(rowp + bj * HALF) = w; } }
    }
};
struct EpiMl {
    static constexpr bool PERM = true;
    bf16_t* O; float* gates; const float* bias;
    __device__ __forceinline__ void operator()(const f32x4 (&acc)[2][2][4][2], const Unit& u, int wr, int wc, int fr, int fq) const {
        if (u.pn < 12) { EpiBf16 e{O, NPROJ, 512, 0.125f}; e(acc, u, wr, wc, fr, fq); return; }
        if (wc != 0) return;
        const int row0 = u.pm * BM + wr * 64 + fr;
        const f32x4 b0 = *(const f32x4*)(bias + 8 * fq), b1 = *(const f32x4*)(bias + 8 * fq + 4);
#pragma unroll
        for (int ai = 0; ai < 2; ++ai)
#pragma unroll
            for (int m = 0; m < 4; ++m) { float* gp = gates + (size_t)(row0 + ai * HALF + m * 16) * 32 + 8 * fq;
                *(f32x4*)gp = acc[ai][0][m][0] + b0; *(f32x4*)(gp + 4) = acc[ai][0][m][1] + b1; }
    }
};
struct EpiSwiglu {
    static constexpr bool PERM = true;
    bf16_t* H;
    __device__ __forceinline__ void operator()(const f32x4 (&acc)[2][2][4][2], const Unit& u, int wr, int wc, int fr, int fq) const {
        const int row0 = u.pm * BM + wr * 64 + fr; const int col0 = u.pn * HALF + wc * 32 + 8 * fq;
#pragma unroll
        for (int ai = 0; ai < 2; ++ai)
#pragma unroll
            for (int m = 0; m < 4; ++m) { bf16_t* rowp = H + (size_t)(row0 + ai * HALF + m * 16) * DFF + col0;
                float r[8];
#pragma unroll
                for (int n = 0; n < 2; ++n)
#pragma unroll
                    for (int e = 0; e < 4; ++e) { const float gt = acc[ai][0][m][n][e], up = acc[ai][1][m][n][e];
                        r[n * 4 + e] = gt * __builtin_amdgcn_rcpf(1.f + __expf(-gt)) * up; }
                u32x4 w; w.x = cvt_pk_bf16(r[0], r[1]); w.y = cvt_pk_bf16(r[2], r[3]); w.z = cvt_pk_bf16(r[4], r[5]); w.w = cvt_pk_bf16(r[6], r[7]);
                *(u32x4*)rowp = w; }
    }
};

template <class Epi, class Sched>
__device__ __forceinline__ void gemm_phase(LAS unsigned char* lds, const Gemm g, const Sched& S, const Epi& E) {
    const int tid = threadIdx.x, wid = __builtin_amdgcn_readfirstlane(tid >> 6), lane = tid & 63, wr = wid >> 2, wc = wid & 3, fr = lane & 15, fq = lane >> 4;
    const int K = g.K, nt = K / BK;
    unsigned voffA[2], voffB[2];
#pragma unroll
    for (int i = 0; i < 2; ++i) { int R, C; stage_rc(tid * 16 + i * 8192, R, C); const int Rb = Epi::PERM ? ((R & ~31) + perm32(R & 31)) : R;
        voffA[i] = (unsigned)(R * g.lda + C) * 2u; voffB[i] = (unsigned)(Rb * K + C) * 2u; }
    const size_t kstep = (size_t)(BK * 2);
    const size_t hA = (size_t)HALF * g.lda * 2, hB = (size_t)HALF * K * 2;
    const size_t tA = 2 * hA, tB = 2 * hB;
    const unsigned ldsw = (unsigned)wid * 1024u;
    const int aoff = lds_byte(wr * 64 + fr, fq * 8), boff = lds_byte(wc * 32 + fr, fq * 8);
#define PG8_SA(b, h) (((b) * 2 + (h)) * HTB)
#define PG8_SB(b, h) ((4 + (b) * 2 + (h)) * HTB)
#define PG8_STAGE(bufoff, gbase, voff) do { _Pragma("unroll") for (int _i = 0; _i < 2; ++_i) \
        __builtin_amdgcn_global_load_lds((const unsigned*)((const char*)(gbase) + (voff)[_i]), (LAS unsigned*)(lds + (bufoff) + ldsw + _i * 8192), 16, 0, 0); } while (0)
#define PG8_LDA(dst, b, h) do { _Pragma("unroll") for (int m = 0; m < 4; ++m) _Pragma("unroll") for (int k = 0; k < 2; ++k) dst[m][k] = *(const LAS bf16x8*)(lds + PG8_SA(b, h) + aoff + m * 2048 + k * 1024); } while (0)
#define PG8_LDB(dst, b, h) do { _Pragma("unroll") for (int n = 0; n < 2; ++n) _Pragma("unroll") for (int k = 0; k < 2; ++k) dst[n][k] = *(const LAS bf16x8*)(lds + PG8_SB(b, h) + boff + n * 2048 + k * 1024); } while (0)
#define PG8_MMA(ai, bj, At, Bt) do { __builtin_amdgcn_s_setprio(1); _Pragma("unroll") for (int m = 0; m < 4; ++m) _Pragma("unroll") for (int n = 0; n < 2; ++n) _Pragma("unroll") for (int k = 0; k < 2; ++k) \
        acc[ai][bj][m][n] = __builtin_amdgcn_mfma_f32_16x16x32_bf16(Bt[n][k], At[m][k], acc[ai][bj][m][n], 0, 0, 0); __builtin_amdgcn_s_setprio(0); } while (0)
#define PG8_WAIT_V(n) asm volatile("s_waitcnt vmcnt(" #n ")" ::: "memory")
#define PG8_WAIT_L(n) asm volatile("s_waitcnt lgkmcnt(" #n ")" ::: "memory")
#define PG8_BAR __builtin_amdgcn_s_barrier()
#define PG8_SCHED __builtin_amdgcn_sched_barrier(0)
    Unit cur, nxt; int ui = 0;
    if (!S.next(0, cur)) return;
    f32x4 acc[2][2][4][2];
#pragma unroll
    for (int a = 0; a < 2; ++a)
#pragma unroll
        for (int b = 0; b < 2; ++b)
#pragma unroll
            for (int m = 0; m < 4; ++m)
#pragma unroll
                for (int n = 0; n < 2; ++n) acc[a][b][m][n] = (f32x4){0.f, 0.f, 0.f, 0.f};
    bf16x8 At[4][2], B0[2][2], B1[2][2];
    const char* cA = (const char*)g.A + (size_t)cur.pm * tA; const char* cB = (const char*)g.Bt + (size_t)cur.pn * tB;
    PG8_STAGE(PG8_SB(0, 0), cB, voffB); PG8_STAGE(PG8_SB(0, 1), cB + hB, voffB); PG8_STAGE(PG8_SA(0, 0), cA, voffA); PG8_STAGE(PG8_SA(0, 1), cA + hA, voffA);
    if (wr == 1) PG8_BAR;
    PG8_WAIT_V(2); PG8_BAR;
    PG8_STAGE(PG8_SB(1, 0), cB + kstep, voffB); PG8_STAGE(PG8_SA(1, 0), cA + kstep, voffA); PG8_STAGE(PG8_SB(1, 1), cB + hB + kstep, voffB);
    PG8_WAIT_V(6); PG8_BAR;
    for (;;) {
        const bool has_next = S.next(ui + 1, nxt);
        const char* nA = has_next ? (const char*)g.A + (size_t)nxt.pm * tA : cA; const char* nB = has_next ? (const char*)g.Bt + (size_t)nxt.pn * tB : cB;
        for (int t = 0; t < nt; t += 2) {
            const bool last = (t == nt - 2);
            const char* a1 = cA + (size_t)(t + 1) * kstep;
            const char* a2 = last ? nA : cA + (size_t)(t + 2) * kstep; const char* b2 = last ? nB : cB + (size_t)(t + 2) * kstep;
            const char* a3 = a2 + kstep; const char* b3 = b2 + kstep;
            PG8_LDB(B0, 0, 0); PG8_LDB(B1, 0, 1); PG8_SCHED; PG8_LDA(At, 0, 0); PG8_STAGE(PG8_SA(1, 1), a1 + hA, voffA);
            PG8_WAIT_V(8); PG8_WAIT_L(0); PG8_BAR; PG8_MMA(0, 0, At, B0); PG8_MMA(0, 1, At, B1); PG8_BAR; PG8_SCHED;
            PG8_LDA(At, 0, 1); PG8_STAGE(PG8_SB(0, 0), b2, voffB); PG8_STAGE(PG8_SB(0, 1), b2 + hB, voffB); PG8_STAGE(PG8_SA(0, 0), a2, voffA);
            PG8_WAIT_V(8); PG8_WAIT_L(0); PG8_BAR; PG8_MMA(1, 0, At, B0); PG8_MMA(1, 1, At, B1); PG8_BAR; PG8_SCHED;
            PG8_LDB(B0, 1, 0); PG8_LDB(B1, 1, 1); PG8_SCHED; PG8_LDA(At, 1, 0); PG8_STAGE(PG8_SA(0, 1), a2 + hA, voffA);
            PG8_WAIT_V(8); PG8_WAIT_L(0); PG8_BAR; PG8_MMA(0, 0, At, B0); PG8_MMA(0, 1, At, B1); PG8_BAR; PG8_SCHED;
            PG8_LDA(At, 1, 1); PG8_STAGE(PG8_SB(1, 0), b3, voffB); PG8_STAGE(PG8_SB(1, 1), b3 + hB, voffB); PG8_STAGE(PG8_SA(1, 0), a3, voffA);
            PG8_WAIT_V(8); PG8_WAIT_L(0); PG8_BAR; PG8_MMA(1, 0, At, B0); PG8_MMA(1, 1, At, B1); PG8_BAR; PG8_SCHED;
        }
        if (wr == 0) PG8_BAR;
        E(acc, cur, wr, wc, fr, fq);
        if (!has_next) break;
#pragma unroll
        for (int a = 0; a < 2; ++a)
#pragma unroll
            for (int b = 0; b < 2; ++b)
#pragma unroll
                for (int m = 0; m < 4; ++m)
#pragma unroll
                    for (int n = 0; n < 2; ++n) acc[a][b][m][n] = (f32x4){0.f, 0.f, 0.f, 0.f};
        cur = nxt; cA = nA; cB = nB; ++ui;
        if (wr == 1) PG8_BAR;
    }
    PG8_WAIT_V(0);
    PG8_BAR;
#undef PG8_SA
#undef PG8_SB
#undef PG8_STAGE
#undef PG8_LDA
#undef PG8_LDB
#undef PG8_MMA
#undef PG8_WAIT_V
#undef PG8_WAIT_L
#undef PG8_BAR
#undef PG8_SCHED
}
}

struct Params {
    const float *xp, *xs, *norms, *cin, *cw, *cout, *mlin, *bgate, *mlnorm, *mlout, *fin, *fout;
    float* out; unsigned char* ws; int ph_lo, ph_hi;
};
struct Frame { LAS unsigned char* lds; int tid, lane, wave, G, bid; };

__device__ __forceinline__ float wave_sum(float v) {
#pragma unroll
    for (int o = 1; o < 64; o <<= 1) v += __shfl_xor(v, o);
    return v;
}
__device__ __forceinline__ float wave_max(float v) {
#pragma unroll
    for (int o = 1; o < 64; o <<= 1) v = fmaxf(v, __shfl_xor(v, o));
    return v;
}
__device__ __forceinline__ float scan_add_up(float v, int lane) {
#pragma unroll
    for (int o = 1; o < 64; o <<= 1) { const float t = __shfl_up(v, o); if (lane >= o) v += t; }
    return v;
}
__device__ __forceinline__ float scan_add_down(float v, int lane) {
#pragma unroll
    for (int o = 1; o < 64; o <<= 1) { const float t = __shfl_down(v, o); if (lane + o < 64) v += t; }
    return v;
}
__device__ __forceinline__ float scan_max_up(float v, int lane) {
#pragma unroll
    for (int o = 1; o < 64; o <<= 1) { const float t = __shfl_up(v, o); if (lane >= o) v = fmaxf(v, t); }
    return v;
}
__device__ __forceinline__ float scan_max_down(float v, int lane) {
#pragma unroll
    for (int o = 1; o < 64; o <<= 1) { const float t = __shfl_down(v, o); if (lane + o < 64) v = fmaxf(v, t); }
    return v;
}
__device__ __forceinline__ const float* xrow_ptr(const Params& p, int t) { return t < TP ? p.xp + (size_t)t * DM : p.xs + (size_t)(t - TP) * DM; }

__device__ __forceinline__ void p0_transpose_item(const float* W, int K, int N, bf16_t* WT, int mode, LAS float* scr, int item, int lane) {
    const int nblk = N / 32, kb = item / nblk, nb = item % nblk, k0 = 64 * kb, n0 = 32 * nb;
    int r0 = n0;
    if (mode == 1) { r0 = (n0 < DFF) ? (256 * (n0 / 128) + (n0 % 128)) : (256 * ((n0 - DFF) / 128) + 128 + ((n0 - DFF) % 128)); }
#pragma unroll 8
    for (int i = 0; i < 32; ++i) { const int kk = 2 * i + (lane >> 5); scr[kk * 33 + (lane & 31)] = W[(size_t)(k0 + kk) * N + n0 + (lane & 31)]; }
    asm volatile("s_waitcnt lgkmcnt(0)" ::: "memory");
    const int c = lane & 7;
#pragma unroll
    for (int j = 0; j < 4; ++j) { const int n = (lane >> 3) + 8 * j; const LAS float* s = scr + (8 * c) * 33 + n;
        u32x4 o; o.x = cvt_pk_bf16(s[0 * 33], s[1 * 33]); o.y = cvt_pk_bf16(s[2 * 33], s[3 * 33]); o.z = cvt_pk_bf16(s[4 * 33], s[5 * 33]); o.w = cvt_pk_bf16(s[6 * 33], s[7 * 33]);
        *(u32x4*)(WT + (size_t)(r0 + n) * K + k0 + 8 * c) = o; }
    asm volatile("s_waitcnt lgkmcnt(0)" ::: "memory");
}
__device__ __forceinline__ void rms_row_first(const float* xrow, const float* g, bf16_t* orow, int lane) {
    const f32x4* xr = (const f32x4*)xrow + lane; const f32x4* gr = (const f32x4*)g + lane;
    f32x4 v[4]; float s = 0.f;
#pragma unroll
    for (int j = 0; j < 4; ++j) { v[j] = xr[64 * j]; s += (v[j].x * v[j].x + v[j].y * v[j].y) + (v[j].z * v[j].z + v[j].w * v[j].w); }
    const float rs = rsqrtf(wave_sum(s) * (1.f / DM) + EPS);
    u32x2* o8 = (u32x2*)orow + lane;
#pragma unroll
    for (int j = 0; j < 4; ++j) { const f32x4 gg = gr[64 * j]; u32x2 w; w.x = cvt_pk_bf16(v[j].x * rs * gg.x, v[j].y * rs * gg.y); w.y = cvt_pk_bf16(v[j].z * rs * gg.z, v[j].w * rs * gg.w); o8[64 * j] = w; }
}
__device__ __forceinline__ void rms_row_mid(const bf16_t* mixrow, const float* xin, float* xout, const float* g1, const float* g2, bf16_t* xnrow, int lane) {
    const u32x2* mr = (const u32x2*)mixrow + lane; const f32x4* xr = (const f32x4*)xin + lane; const f32x4* g1r = (const f32x4*)g1 + lane;
    f32x4 mv[4], xv[4]; float s = 0.f;
#pragma unroll
    for (int j = 0; j < 4; ++j) { const u32x2 w = mr[64 * j]; mv[j] = (f32x4){bflo(w.x), bfhi(w.x), bflo(w.y), bfhi(w.y)}; xv[j] = xr[64 * j];
        s += (mv[j].x * mv[j].x + mv[j].y * mv[j].y) + (mv[j].z * mv[j].z + mv[j].w * mv[j].w); }
    const float rs1 = rsqrtf(wave_sum(s) * (1.f / DM) + EPS);
    float s2 = 0.f;
#pragma unroll
    for (int j = 0; j < 4; ++j) { const f32x4 gg = g1r[64 * j]; xv[j] = xv[j] + mv[j] * rs1 * gg; ((f32x4*)xout + lane)[64 * j] = xv[j];
        s2 += (xv[j].x * xv[j].x + xv[j].y * xv[j].y) + (xv[j].z * xv[j].z + xv[j].w * xv[j].w); }
    if (g2) {
        const float rs2 = rsqrtf(wave_sum(s2) * (1.f / DM) + EPS);
        const f32x4* g2r = (const f32x4*)g2 + lane; u32x2* o8 = (u32x2*)xnrow + lane;
#pragma unroll
        for (int j = 0; j < 4; ++j) { const f32x4 gg = g2r[64 * j]; u32x2 w; w.x = cvt_pk_bf16(xv[j].x * rs2 * gg.x, xv[j].y * rs2 * gg.y); w.y = cvt_pk_bf16(xv[j].z * rs2 * gg.z, xv[j].w * rs2 * gg.w); o8[64 * j] = w; }
    }
}
__device__ __forceinline__ void phase_prologue(const Frame& F, const Params& p) {
    LAS float* scr = (LAS float*)(F.lds + F.wave * 16384);
    const int gw = F.bid * 8 + F.wave, NGW = F.G * 8;
    unsigned char* ws = p.ws;
    constexpr int I_CIN = 16 * 96, I_COUT = 16 * 32, I_MLIN = 16 * 97, I_MLOUT = 16 * 32, I_FIN = 16 * 176, I_FOUT = 44 * 32;
    constexpr int NITEMS = I_CIN + I_COUT + I_MLIN + I_MLOUT + 2 * I_FIN + 2 * I_FOUT;
    for (int it = gw; it < NITEMS; it += NGW) {
        int r = it;
        if (r < I_CIN) { p0_transpose_item(p.cin, DM, 3072, (bf16_t*)(ws + WS_W_CIN), 0, scr, r, F.lane); continue; } r -= I_CIN;
        if (r < I_COUT) { p0_transpose_item(p.cout, DM, DM, (bf16_t*)(ws + WS_W_COUT), 0, scr, r, F.lane); continue; } r -= I_COUT;
        if (r < I_MLIN) { p0_transpose_item(p.mlin, DM, 3104, (bf16_t*)(ws + WS_W_MLIN), 0, scr, r, F.lane); continue; } r -= I_MLIN;
        if (r < I_MLOUT) { p0_transpose_item(p.mlout, DM, DM, (bf16_t*)(ws + WS_W_MLOUT), 0, scr, r, F.lane); continue; } r -= I_MLOUT;
        if (r < I_FIN) { p0_transpose_item(p.fin, DM, NFF, (bf16_t*)(ws + WS_W_FIN0), 1, scr, r, F.lane); continue; } r -= I_FIN;
        if (r < I_FIN) { p0_transpose_item(p.fin + (size_t)DM * NFF, DM, NFF, (bf16_t*)(ws + WS_W_FIN1), 1, scr, r, F.lane); continue; } r -= I_FIN;
        if (r < I_FOUT) { p0_transpose_item(p.fout, DFF, DM, (bf16_t*)(ws + WS_W_FOUT0), 0, scr, r, F.lane); continue; } r -= I_FOUT;
        p0_transpose_item(p.fout + (size_t)DFF * DM, DFF, DM, (bf16_t*)(ws + WS_W_FOUT1), 0, scr, r, F.lane);
    }
    {
        u32x4* z = (u32x4*)(ws + WS_W_MLIN + (size_t)3104 * DM * 2); const int n16 = (NML - 3104) * DM * 2 / 16;
        for (int i = F.bid * 512 + F.tid; i < n16; i += F.G * 512) z[i] = (u32x4){0u, 0u, 0u, 0u};
    }
    bf16_t* XN = (bf16_t*)(ws + WS_XN);
    for (int m = gw; m < T; m += NGW) rms_row_first(xrow_ptr(p, m), p.norms, XN + (size_t)m * DM, F.lane);
}
__device__ __forceinline__ void phase_rownorm(const Frame& F, const Params& p, const bf16_t* mix, bool from_input, const float* g1, const float* g2, bf16_t* xn) {
    const int gw = F.bid * 8 + F.wave, NGW = F.G * 8;
    for (int m = gw; m < T; m += NGW) {
        const float* xin = from_input ? xrow_ptr(p, m) : p.out + (size_t)m * DM;
        rms_row_mid(mix + (size_t)m * DM, xin, p.out + (size_t)m * DM, g1, g2, xn ? xn + (size_t)m * DM : nullptr, F.lane);
    }
}
__device__ __forceinline__ void load_u8(const bf16_t* proj, int t, int c0, bool valid, float (&u)[8]) {
    if (!valid) {
#pragma unroll
        for (int e = 0; e < 8; ++e) u[e] = 0.f;
        return; }
    const u32x4 cc = *(const u32x4*)(proj + (size_t)t * NPROJ + DM + c0), vv = *(const u32x4*)(proj + (size_t)t * NPROJ + 2 * DM + c0);
    u[0] = bflo(cc.x) * bflo(vv.x); u[1] = bfhi(cc.x) * bfhi(vv.x); u[2] = bflo(cc.y) * bflo(vv.y); u[3] = bfhi(cc.y) * bfhi(vv.y);
    u[4] = bflo(cc.z) * bflo(vv.z); u[5] = bfhi(cc.z) * bfhi(vv.z); u[6] = bflo(cc.w) * bflo(vv.w); u[7] = bfhi(cc.w) * bfhi(vv.w);
}
__device__ __forceinline__ void phase_conv(const Frame& F, const Params& p, const bf16_t* proj, bf16_t* gout) {
    const int c0 = (F.tid & 127) * 8, rs = F.tid >> 7;
    float w0[8], w1[8], w2[8];
#pragma unroll
    for (int e = 0; e < 8; ++e) { w0[e] = p.cw[c0 + e]; w1[e] = p.cw[DM + c0 + e]; w2[e] = p.cw[2 * DM + c0 + e]; }
    for (int tile = F.bid; tile < T / 64; tile += F.G) {
        const int t0 = tile * 64 + rs * 16;
        const int S = (t0 < TP) ? SEQ_P : SEQ_S;
        float up[8], uc[8], un[8];
        { const int pos = (t0 < TP ? t0 : t0 - TP) & (S - 1); load_u8(proj, t0 - 1, c0, pos != 0, up); load_u8(proj, t0, c0, true, uc); }
        for (int i = 0; i < 16; ++i) {
            const int t = t0 + i; const int pos = (t < TP ? t : t - TP) & (S - 1);
            load_u8(proj, t + 1, c0, pos != S - 1, un);
            const u32x4 bb = *(const u32x4*)(proj + (size_t)t * NPROJ + c0);
            float bv[8] = {bflo(bb.x), bfhi(bb.x), bflo(bb.y), bfhi(bb.y), bflo(bb.z), bfhi(bb.z), bflo(bb.w), bfhi(bb.w)};
            float r[8];
#pragma unroll
            for (int e = 0; e < 8; ++e) { r[e] = bv[e] * (w0[e] * up[e] + w1[e] * uc[e] + w2[e] * un[e]); up[e] = uc[e]; uc[e] = un[e]; }
            u32x4 w; w.x = cvt_pk_bf16(r[0], r[1]); w.y = cvt_pk_bf16(r[2], r[3]); w.z = cvt_pk_bf16(r[4], r[5]); w.w = cvt_pk_bf16(r[6], r[7]);
            *(u32x4*)(gout + (size_t)t * DM + c0) = w;
        }
    }
}

__device__ __forceinline__ s16x4 tr4(LAS unsigned char* p) { return __builtin_amdgcn_ds_read_tr16_b64_v4i16((LAS s16x4*)p); }
__device__ __forceinline__ f32x4 mfma16(bf16x8 a, bf16x8 b, f32x4 c) { return __builtin_amdgcn_mfma_f32_16x16x32_bf16(a, b, c, 0, 0, 0); }
__device__ __forceinline__ bf16x8 cat4(s16x4 a, s16x4 b) { return (bf16x8){a[0], a[1], a[2], a[3], b[0], b[1], b[2], b[3]}; }
__device__ __forceinline__ float logsig(float x) { return fminf(x, 0.f) - logf(1.f + expf(-fabsf(x))); }
constexpr int RSK = 160, RSV = 288;

__device__ __forceinline__ void gate_scan(const float* gates, const int tok0, const int h, const int dir, const int lane, float& i0, float& i1, float& B0, float& B1, float& total) {
    const float* g0 = gates + (size_t)(tok0 + 2 * lane) * 32 + 16 * dir + h; const float* g1 = g0 + 32;
    i0 = g0[0]; i1 = g1[0];
    const float lf0 = logsig(g0[8]), lf1 = logsig(g1[8]);
    const float pr = lf0 + lf1;
    if (dir == 0) { const float inc = scan_add_up(pr, lane); const float ex = inc - pr; B0 = ex + lf0; B1 = B0 + lf1; }
    else { const float inc = scan_add_down(pr, lane); const float ex = inc - pr; B1 = ex + lf1; B0 = B1 + lf0; }
    total = wave_sum(pr);
}

__device__ __forceinline__ void phase_m1(const Frame& F, const Params& p) {
    unsigned char* ws = p.ws;
    const bf16_t* proj = (const bf16_t*)(ws + WS_BIG); const float* gates = (const float*)(ws + WS_GATES);
    bf16_t* states = (bf16_t*)(ws + WS_XN); float* nst = (float*)(ws + WS_NST); float* mloc_a = (float*)(ws + WS_MLOC); float* blast_a = (float*)(ws + WS_BLAST);
    LAS unsigned char* wK = F.lds; LAS unsigned char* Vimg = F.lds + 40960; LAS float* wts = (LAS float*)(F.lds + 77824);
    const int lane = F.lane, wave = F.wave, tid = F.tid, g = lane >> 4, li = lane & 15;
    for (int it = F.bid; it < NITEM; it += F.G) {
        const int cgi = it >> 3, h = it & 7, tok0 = cgi * 128;
        if (wave < 2) {
            const int dir = wave; float i0, i1, B0, B1, total; gate_scan(gates, tok0, h, dir, lane, i0, i1, B0, B1, total);
            const float d0 = total - B0 + i0, d1 = total - B1 + i1; const float ml = wave_max(fmaxf(d0, d1));
            wts[dir * 128 + 2 * lane] = expf(d0 - ml); wts[dir * 128 + 2 * lane + 1] = expf(d1 - ml);
            if (lane == 0) { const int id = (cgi * 8 + h) * 2 + dir; mloc_a[id] = ml; blast_a[id] = total; }
        }
        u32x4 kreg[2], vreg[4];
#pragma unroll
        for (int i = 0; i < 2; ++i) { const int idx = tid + 512 * i, row = idx >> 3, ch = idx & 7; kreg[i] = *(const u32x4*)(proj + (size_t)(tok0 + row) * NPROJ + 512 + 64 * h + 8 * ch); }
#pragma unroll
        for (int i = 0; i < 4; ++i) { const int idx = tid + 512 * i, row = idx >> 4, ch = idx & 15; vreg[i] = *(const u32x4*)(proj + (size_t)(tok0 + row) * NPROJ + 1024 + 128 * h + 8 * ch); }
        __syncthreads();
#pragma unroll
        for (int i = 0; i < 4; ++i) { const int idx = tid + 512 * i, row = idx >> 4, ch = idx & 15; *(LAS u32x4*)(Vimg + row * RSV + ch * 16) = vreg[i]; }
#pragma unroll
        for (int i = 0; i < 2; ++i) { const int idx = tid + 512 * i, row = idx >> 3, ch = idx & 7; const u32x4 k = kreg[i];
#pragma unroll
            for (int dir = 0; dir < 2; ++dir) { const float w = wts[dir * 128 + row]; u32x4 o;
                o.x = cvt_pk_bf16(bflo(k.x) * w, bfhi(k.x) * w); o.y = cvt_pk_bf16(bflo(k.y) * w, bfhi(k.y) * w); o.z = cvt_pk_bf16(bflo(k.z) * w, bfhi(k.z) * w); o.w = cvt_pk_bf16(bflo(k.w) * w, bfhi(k.w) * w);
                *(LAS u32x4*)(wK + dir * 20480 + row * RSK + ch * 16) = o; } }
        __syncthreads();
        {
            const int dir = wave >> 2, dt = wave & 3, id = (cgi * 8 + h) * 2 + dir;
            f32x4 acc[8], accn = (f32x4){0.f, 0.f, 0.f, 0.f};
#pragma unroll
            for (int vt = 0; vt < 8; ++vt) acc[vt] = (f32x4){0.f, 0.f, 0.f, 0.f};
            const bf16x8 ones = (bf16x8){0x3F80, 0x3F80, 0x3F80, 0x3F80, 0x3F80, 0x3F80, 0x3F80, 0x3F80};
            LAS unsigned char* abase = wK + dir * 20480 + (8 * g + (li >> 2)) * RSK + (16 * dt + 4 * (li & 3)) * 2;
            LAS unsigned char* bbase = Vimg + (8 * g + (li >> 2)) * RSV + (4 * (li & 3)) * 2;
#pragma unroll
            for (int ks = 0; ks < 4; ++ks) {
                const bf16x8 A = cat4(tr4(abase + (32 * ks) * RSK), tr4(abase + (32 * ks + 4) * RSK));
#pragma unroll
                for (int vt = 0; vt < 8; ++vt) { const bf16x8 B = cat4(tr4(bbase + (32 * ks) * RSV + 32 * vt), tr4(bbase + (32 * ks + 4) * RSV + 32 * vt)); acc[vt] = mfma16(A, B, acc[vt]); }
                accn = mfma16(A, ones, accn);
            }
            bf16_t* Ct = states + (size_t)id * 8192;
#pragma unroll
            for (int vt = 0; vt < 8; ++vt) { u32x2 w; w.x = cvt_pk_bf16(acc[vt][0], acc[vt][1]); w.y = cvt_pk_bf16(acc[vt][2], acc[vt][3]); *(u32x2*)(Ct + (16 * vt + li) * 64 + 16 * dt + 4 * g) = w; }
            if (li == 0) *(f32x4*)(nst + (size_t)id * 64 + 16 * dt + 4 * g) = accn;
        }
    }
}

__device__ __forceinline__ void phase_m2(const Frame& F, const Params& p) {
    unsigned char* ws = p.ws;
    bf16_t* states = (bf16_t*)(ws + WS_XN); float* nst = (float*)(ws + WS_NST); const float* mloc_a = (const float*)(ws + WS_MLOC); const float* blast_a = (const float*)(ws + WS_BLAST); float* mst = (float*)(ws + WS_MST);
    constexpr int GPS = 1032;
    const int NU = 288 * GPS;
    for (int u = F.bid * 512 + F.tid; u < NU; u += F.G * 512) {
        const int stream = u / GPS, grp = u - stream * GPS;
        const int b = stream >> 4, h = (stream >> 1) & 7, dir = stream & 1;
        const int nc = (b < 2) ? 64 : 16, cbase = (b < 2) ? b * 64 : 128 + (b - 2) * 16;
        float C[8]; float m = 0.f;
#pragma unroll
        for (int e = 0; e < 8; ++e) C[e] = 0.f;
        for (int j0 = 0; j0 < nc; j0 += 4) {
            float D[4][8]; float ml[4], bl[4]; int ids[4];
#pragma unroll
            for (int jj = 0; jj < 4; ++jj) { const int j = j0 + jj, c = dir ? nc - 1 - j : j; const int id = ((cbase + c) * 8 + h) * 2 + dir; ids[jj] = id;
                ml[jj] = mloc_a[id]; bl[jj] = blast_a[id];
                if (grp < 1024) { const u32x4 w = *(const u32x4*)(states + (size_t)id * 8192 + grp * 8);
                    D[jj][0] = bflo(w.x); D[jj][1] = bfhi(w.x); D[jj][2] = bflo(w.y); D[jj][3] = bfhi(w.y); D[jj][4] = bflo(w.z); D[jj][5] = bfhi(w.z); D[jj][6] = bflo(w.w); D[jj][7] = bfhi(w.w); }
                else { const f32x4* q = (const f32x4*)(nst + (size_t)id * 64 + (grp - 1024) * 8); const f32x4 a = q[0], c2 = q[1];
                    D[jj][0] = a.x; D[jj][1] = a.y; D[jj][2] = a.z; D[jj][3] = a.w; D[jj][4] = c2.x; D[jj][5] = c2.y; D[jj][6] = c2.z; D[jj][7] = c2.w; } }
#pragma unroll
            for (int jj = 0; jj < 4; ++jj) { const int id = ids[jj];
                if (grp < 1024) { u32x4 w; w.x = cvt_pk_bf16(C[0], C[1]); w.y = cvt_pk_bf16(C[2], C[3]); w.z = cvt_pk_bf16(C[4], C[5]); w.w = cvt_pk_bf16(C[6], C[7]); *(u32x4*)(states + (size_t)id * 8192 + grp * 8) = w;
                    if (grp == 0) mst[id] = m; }
                else { f32x4* q = (f32x4*)(nst + (size_t)id * 64 + (grp - 1024) * 8); q[0] = (f32x4){C[0], C[1], C[2], C[3]}; q[1] = (f32x4){C[4], C[5], C[6], C[7]}; }
                const float mn = fmaxf(bl[jj] + m, ml[jj]); const float dec = expf(bl[jj] + m - mn), sc = expf(ml[jj] - mn);
#pragma unroll
                for (int e = 0; e < 8; ++e) C[e] = dec * C[e] + sc * D[jj][e];
                m = mn; }
        }
    }
}

__device__ __forceinline__ void phase_m3(const Frame& F, const Params& p) {
    unsigned char* ws = p.ws;
    bf16_t* proj = (bf16_t*)(ws + WS_BIG); const float* gates = (const float*)(ws + WS_GATES);
    const bf16_t* states = (const bf16_t*)(ws + WS_XN); const float* nst = (const float*)(ws + WS_NST); const float* mst = (const float*)(ws + WS_MST);
    LAS unsigned char* Kimg = F.lds; LAS unsigned char* Vimg = F.lds + 20480; LAS unsigned char* Cimg = F.lds + 57344;
    LAS float* SC = (LAS float*)(F.lds + 98304); LAS float* NV = SC + 768; LAS float* Hx = (LAS float*)F.lds;
    const int lane = F.lane, wave = F.wave, tid = F.tid, g = lane >> 4, li = lane & 15;
    for (int it = F.bid; it < NITEM; it += F.G) {
        const int cgi = it >> 3, h = it & 7, tok0 = cgi * 128;
        if (wave < 2) {
            const int dir = wave; const int id = (cgi * 8 + h) * 2 + dir; const float ms = mst[id];
            float i0, i1, B0, B1, total; gate_scan(gates, tok0, h, dir, lane, i0, i1, B0, B1, total);
            const float a0 = i0 - B0, a1 = i1 - B1; const float pl = fmaxf(a0, a1); float pm0, pm1;
            if (dir == 0) { const float inc = scan_max_up(pl, lane); float ex = __shfl_up(inc, 1); if (lane == 0) ex = -INFINITY; pm0 = fmaxf(ex, a0); pm1 = fmaxf(pm0, a1); }
            else { const float inc = scan_max_down(pl, lane); float ex = __shfl_down(inc, 1); if (lane == 63) ex = -INFINITY; pm1 = fmaxf(ex, a1); pm0 = fmaxf(pm1, a0); }
            LAS float* Bv = SC + dir * 384;
            Bv[2 * lane] = B0; Bv[2 * lane + 1] = B1; Bv[128 + 2 * lane] = a0; Bv[128 + 2 * lane + 1] = a1;
            Bv[256 + 2 * lane] = fmaxf(B0 + ms, B0 + pm0); Bv[256 + 2 * lane + 1] = fmaxf(B1 + ms, B1 + pm1);
        }
        u32x4 kreg[2], vreg[4], creg[4];
#pragma unroll
        for (int i = 0; i < 2; ++i) { const int idx = tid + 512 * i, row = idx >> 3, ch = idx & 7; kreg[i] = *(const u32x4*)(proj + (size_t)(tok0 + row) * NPROJ + 512 + 64 * h + 8 * ch); }
#pragma unroll
        for (int i = 0; i < 4; ++i) { const int idx = tid + 512 * i, row = idx >> 4, ch = idx & 15; vreg[i] = *(const u32x4*)(proj + (size_t)(tok0 + row) * NPROJ + 1024 + 128 * h + 8 * ch); }
#pragma unroll
        for (int i = 0; i < 4; ++i) { const int idx = tid + 512 * (i & 1), dir = i >> 1; creg[i] = *(const u32x4*)(states + (size_t)((cgi * 8 + h) * 2 + dir) * 8192 + idx * 8); }
        if (tid < 128) NV[tid] = nst[(size_t)((cgi * 8 + h) * 2 + (tid >> 6)) * 64 + (tid & 63)];
#pragma unroll
        for (int i = 0; i < 2; ++i) { const int idx = tid + 512 * i, row = idx >> 3, ch = idx & 7; *(LAS u32x4*)(Kimg + row * RSK + ch * 16) = kreg[i]; }
#pragma unroll
        for (int i = 0; i < 4; ++i) { const int idx = tid + 512 * i, row = idx >> 4, ch = idx & 15; *(LAS u32x4*)(Vimg + row * RSV + ch * 16) = vreg[i]; }
#pragma unroll
        for (int i = 0; i < 4; ++i) { const int idx = tid + 512 * (i & 1), dir = i >> 1, row = idx >> 3, ch = idx & 7; *(LAS u32x4*)(Cimg + dir * 20480 + row * RSK + ch * 16) = creg[i]; }
        __syncthreads();
        const int dir = wave >> 2, jw = wave & 3;
        f32x4 acc[2][8];
        float emt[2], den[2];
        {
            const int id = (cgi * 8 + h) * 2 + dir; const float ms = mst[id];
            const LAS float* Bv = SC + dir * 384; const LAS float* av = Bv + 128; const LAS float* mtv = Bv + 256; const LAS float* nv = NV + dir * 64;
            bf16x8 qf[2][2], qs[2][2]; float bm[2];
#pragma unroll
            for (int tt = 0; tt < 2; ++tt) {
                const int tau = tt ? 7 - jw : jw, t = 16 * tau + li;
                const bf16_t* qrow = proj + (size_t)(tok0 + t) * NPROJ + 64 * h + 8 * g;
                qf[tt][0] = *(const bf16x8*)qrow; qf[tt][1] = *(const bf16x8*)(qrow + 32);
                const float Bt = Bv[t], mt = mtv[t]; bm[tt] = Bt - mt; const float winter = expf(Bt + ms - mt); emt[tt] = expf(-mt);
                float dq = 0.f;
#pragma unroll
                for (int ks = 0; ks < 2; ++ks)
#pragma unroll
                    for (int j = 0; j < 8; ++j) dq += bf2f((unsigned short)qf[tt][ks][j]) * nv[32 * ks + 8 * g + j];
                dq += __shfl_xor(dq, 16); dq += __shfl_xor(dq, 32);
                den[tt] = winter * dq;
#pragma unroll
                for (int ks = 0; ks < 2; ++ks) { bf16x8 o;
#pragma unroll
                    for (int j = 0; j < 8; j += 2) { const unsigned w = cvt_pk_bf16(bf2f((unsigned short)qf[tt][ks][j]) * winter, bf2f((unsigned short)qf[tt][ks][j + 1]) * winter); o[j] = (short)(w & 0xffffu); o[j + 1] = (short)(w >> 16); }
                    qs[tt][ks] = o; }
#pragma unroll
                for (int vt = 0; vt < 8; ++vt) acc[tt][vt] = (f32x4){0.f, 0.f, 0.f, 0.f};
            }
#pragma unroll
            for (int vt = 0; vt < 8; ++vt)
#pragma unroll
                for (int ks = 0; ks < 2; ++ks) { const bf16x8 A = *(const LAS bf16x8*)(Cimg + dir * 20480 + (16 * vt + li) * RSK + (32 * ks + 8 * g) * 2);
                    acc[0][vt] = mfma16(A, qs[0][ks], acc[0][vt]); acc[1][vt] = mfma16(A, qs[1][ks], acc[1][vt]); }
#pragma unroll
            for (int tt = 0; tt < 2; ++tt) {
                const int tau = tt ? 7 - jw : jw, t = 16 * tau + li;
                const int plo = dir ? (tau >> 1) : 0, phi = dir ? 3 : (tau >> 1);
                float rsum = 0.f;
                for (int pp = plo; pp <= phi; ++pp) {
                    bf16x8 pf;
#pragma unroll
                    for (int hf = 0; hf < 2; ++hf) {
                        const int sig = 2 * pp + hf;
                        f32x4 st = (f32x4){0.f, 0.f, 0.f, 0.f};
#pragma unroll
                        for (int ks = 0; ks < 2; ++ks) { const bf16x8 A = *(const LAS bf16x8*)(Kimg + (16 * sig + li) * RSK + (32 * ks + 8 * g) * 2); st = mfma16(A, qf[tt][ks], st); }
                        const f32x4 a4 = *(const LAS f32x4*)(av + 16 * sig + 4 * g);
                        float pe[4];
#pragma unroll
                        for (int e = 0; e < 4; ++e) { const int s = 16 * sig + 4 * g + e; const bool keep = dir ? (s >= t) : (s <= t);
                            pe[e] = keep ? st[e] * __expf(bm[tt] + a4[e]) : 0.f; rsum += pe[e]; }
                        const unsigned w0 = cvt_pk_bf16(pe[0], pe[1]), w1 = cvt_pk_bf16(pe[2], pe[3]);
                        pf[4 * hf + 0] = (short)(w0 & 0xffffu); pf[4 * hf + 1] = (short)(w0 >> 16); pf[4 * hf + 2] = (short)(w1 & 0xffffu); pf[4 * hf + 3] = (short)(w1 >> 16);
                    }
                    LAS unsigned char* vb = Vimg + (32 * pp + 4 * g + (li >> 2)) * RSV + (4 * (li & 3)) * 2;
#pragma unroll
                    for (int vt = 0; vt < 8; ++vt) { const bf16x8 A = cat4(tr4(vb + 32 * vt), tr4(vb + 16 * RSV + 32 * vt)); acc[tt][vt] = mfma16(A, pf, acc[tt][vt]); }
                }
                rsum += __shfl_xor(rsum, 16); rsum += __shfl_xor(rsum, 32);
                den[tt] += rsum;
                const float inv = 1.f / fmaxf(fabsf(den[tt]), emt[tt]);
#pragma unroll
                for (int vt = 0; vt < 8; ++vt) acc[tt][vt] = acc[tt][vt] * inv;
            }
        }
        __syncthreads();
        if (dir == 1) {
#pragma unroll
            for (int tt = 0; tt < 2; ++tt)
#pragma unroll
                for (int vt = 0; vt < 8; ++vt)
#pragma unroll
                    for (int e = 0; e < 4; ++e) Hx[(jw * 64 + (tt * 8 + vt) * 4 + e) * 64 + lane] = acc[tt][vt][e];
        }
        __syncthreads();
        if (dir == 0) {
#pragma unroll
            for (int tt = 0; tt < 2; ++tt) {
                const int tau = tt ? 7 - jw : jw, t = 16 * tau + li;
                float ss = 0.f;
#pragma unroll
                for (int vt = 0; vt < 8; ++vt)
#pragma unroll
                    for (int e = 0; e < 4; ++e) { const float v = acc[tt][vt][e] + Hx[(jw * 64 + (tt * 8 + vt) * 4 + e) * 64 + lane]; acc[tt][vt][e] = v; ss += v * v; }
                ss += __shfl_xor(ss, 16); ss += __shfl_xor(ss, 32);
                const float rs = rsqrtf(ss * (1.f / 128.f) + EPS);
                bf16_t* orow = proj + (size_t)(tok0 + t) * NPROJ + 2048 + 128 * h + 4 * g;
                const float* ng = p.mlnorm + 128 * h + 4 * g;
#pragma unroll
                for (int vt = 0; vt < 8; ++vt) { const u32x2 ow = *(const u32x2*)(orow + 16 * vt); const f32x4 gg = *(const f32x4*)(ng + 16 * vt);
                    const float o0 = bflo(ow.x), o1 = bfhi(ow.x), o2 = bflo(ow.y), o3 = bfhi(ow.y);
                    const float r0 = acc[tt][vt][0] * rs * gg.x * __builtin_amdgcn_rcpf(1.f + __expf(-o0)), r1 = acc[tt][vt][1] * rs * gg.y * __builtin_amdgcn_rcpf(1.f + __expf(-o1));
                    const float r2 = acc[tt][vt][2] * rs * gg.z * __builtin_amdgcn_rcpf(1.f + __expf(-o2)), r3 = acc[tt][vt][3] * rs * gg.w * __builtin_amdgcn_rcpf(1.f + __expf(-o3));
                    u32x2 w; w.x = cvt_pk_bf16(r0, r1); w.y = cvt_pk_bf16(r2, r3); *(u32x2*)(orow + 16 * vt) = w; }
            }
        }
        __syncthreads();
    }
}

constexpr int N_PHASES = 17;
__global__ void __launch_bounds__(512, 2) trunk_fwd(Params p) {
    extern __shared__ __attribute__((aligned(16))) unsigned char lds_raw[];
    Frame F; F.lds = (LAS unsigned char*)lds_raw; F.tid = threadIdx.x; F.lane = F.tid & 63; F.wave = __builtin_amdgcn_readfirstlane(F.tid >> 6); F.G = gridDim.x; F.bid = blockIdx.x;
    unsigned char* ws = p.ws;
    bf16_t* XN = (bf16_t*)(ws + WS_XN); bf16_t* BIG = (bf16_t*)(ws + WS_BIG);
    const int lo = p.ph_lo, hi = p.ph_hi;
#define IN(k) (lo <= (k) && (k) < hi)
#define SEAM(k) do { if (IN(k) && IN((k) + 1)) { cg::this_grid().sync(); } } while (0)
    if (IN(0)) phase_prologue(F, p);
    SEAM(0);
    if (IN(1)) { pg8::Gemm g{XN, (const bf16_t*)(ws + WS_W_CIN), DM, T, NPROJ, DM}; pg8::StaticOrder S; S.init(T, NPROJ, F.G, F.bid);
        pg8::EpiBf16 E{BIG, NPROJ, 0, 1.f}; pg8::gemm_phase(F.lds, g, S, E); }
    SEAM(1);
    if (IN(2)) phase_conv(F, p, BIG, XN);
    SEAM(2);
    if (IN(3)) { pg8::Gemm g{XN, (const bf16_t*)(ws + WS_W_COUT), DM, T, DM, DM}; pg8::StaticOrder S; S.init(T, DM, F.G, F.bid);
        pg8::EpiBf16 E{BIG, DM, 0, 1.f}; pg8::gemm_phase(F.lds, g, S, E); }
    SEAM(3);
    if (IN(4)) phase_rownorm(F, p, BIG, true, p.norms + 1 * DM, p.norms + 2 * DM, XN);
    SEAM(4);
    if (IN(5)) { pg8::Gemm g{XN, (const bf16_t*)(ws + WS_W_FIN0), DM, T, NFF, DM}; pg8::StaticOrder S; S.init(T, NFF, F.G, F.bid);
        pg8::EpiSwiglu E{BIG}; pg8::gemm_phase(F.lds, g, S, E); }
    SEAM(5);
    if (IN(6)) { pg8::Gemm g{BIG, (const bf16_t*)(ws + WS_W_FOUT0), DFF, T, DM, DFF}; pg8::StaticOrder S; S.init(T, DM, F.G, F.bid);
        pg8::EpiBf16 E{XN, DM, 0, 1.f}; pg8::gemm_phase(F.lds, g, S, E); }
    SEAM(6);
    if (IN(7)) phase_rownorm(F, p, XN, false, p.norms + 3 * DM, p.norms + 4 * DM, XN);
    SEAM(7);
    if (IN(8)) { pg8::Gemm g{XN, (const bf16_t*)(ws + WS_W_MLIN), DM, T, NML, DM}; pg8::StaticOrder S; S.init(T, NML, F.G, F.bid);
        pg8::EpiMl E{BIG, (float*)(ws + WS_GATES), p.bgate}; pg8::gemm_phase(F.lds, g, S, E); }
    SEAM(8);
    if (IN(9)) phase_m1(F, p);
    SEAM(9);
    if (IN(10)) phase_m2(F, p);
    SEAM(10);
    if (IN(11)) phase_m3(F, p);
    SEAM(11);
    if (IN(12)) { pg8::Gemm g{BIG + 2048, (const bf16_t*)(ws + WS_W_MLOUT), NPROJ, T, DM, DM}; pg8::StaticOrder S; S.init(T, DM, F.G, F.bid);
        pg8::EpiBf16 E{XN, DM, 0, 1.f}; pg8::gemm_phase(F.lds, g, S, E); }
    SEAM(12);
    if (IN(13)) phase_rownorm(F, p, XN, false, p.norms + 5 * DM, p.norms + 6 * DM, XN);
    SEAM(13);
    if (IN(14)) { pg8::Gemm g{XN, (const bf16_t*)(ws + WS_W_FIN1), DM, T, NFF, DM}; pg8::StaticOrder S; S.init(T, NFF, F.G, F.bid);
        pg8::EpiSwiglu E{BIG}; pg8::gemm_phase(F.lds, g, S, E); }
    SEAM(14);
    if (IN(15)) { pg8::Gemm g{BIG, (const bf16_t*)(ws + WS_W_FOUT1), DFF, T, DM, DFF}; pg8::StaticOrder S; S.init(T, DM, F.G, F.bid);
        pg8::EpiBf16 E{XN, DM, 0, 1.f}; pg8::gemm_phase(F.lds, g, S, E); }
    SEAM(15);
    if (IN(16)) phase_rownorm(F, p, XN, false, p.norms + 7 * DM, nullptr, nullptr);
#undef IN
#undef SEAM
}

extern "C" void kernel_launch(void* const* d_in, const int* in_sizes, int n_in, void* d_out, int out_size, void* d_ws, size_t ws_size, hipStream_t stream) {
    static int grid = 0;
    if (grid == 0) {
        if (n_in != 12 || in_sizes[0] != TP * DM || in_sizes[1] != TSM * DM || out_size != T * DM || ws_size < WS_END) {
            fprintf(stderr, "kernel_launch: unexpected shapes (n_in %d, in0 %d, in1 %d, out %d, ws %zu); nothing launched\n", n_in, n_in > 0 ? in_sizes[0] : -1, n_in > 1 ? in_sizes[1] : -1, out_size, ws_size); grid = -1; return; }
        int dev = 0, cus = 0, per_cu = 0;
        if (hipGetDevice(&dev) != hipSuccess || hipDeviceGetAttribute(&cus, hipDeviceAttributeMultiprocessorCount, dev) != hipSuccess) { grid = -1; return; }
        if (hipFuncSetAttribute((const void*)trunk_fwd, hipFuncAttributeMaxDynamicSharedMemorySize, LDS_BYTES) != hipSuccess) { fprintf(stderr, "kernel_launch: hipFuncSetAttribute failed\n"); grid = -1; return; }
        if (hipOccupancyMaxActiveBlocksPerMultiprocessor(&per_cu, (const void*)trunk_fwd, 512, LDS_BYTES) != hipSuccess || per_cu < 1) { fprintf(stderr, "kernel_launch: occupancy query says %d\n", per_cu); per_cu = 1; }
        (void)hipGetLastError();
        grid = cus * 1;
    }
    if (grid < 0) return;
    Params p{};
    p.xp = (const float*)d_in[0]; p.xs = (const float*)d_in[1]; p.norms = (const float*)d_in[2]; p.cin = (const float*)d_in[3]; p.cw = (const float*)d_in[4]; p.cout = (const float*)d_in[5];
    p.mlin = (const float*)d_in[6]; p.bgate = (const float*)d_in[7]; p.mlnorm = (const float*)d_in[8]; p.mlout = (const float*)d_in[9]; p.fin = (const float*)d_in[10]; p.fout = (const float*)d_in[11];
    p.out = (float*)d_out; p.ws = (unsigned char*)d_ws;
#if MK_ONE_LAUNCH
    p.ph_lo = 0; p.ph_hi = N_PHASES;
    void* args[] = {&p};
    hipError_t e = hipLaunchCooperativeKernel((const void*)trunk_fwd, dim3(grid), dim3(512), args, LDS_BYTES, stream);
    if (e != hipSuccess) fprintf(stderr, "kernel_launch: cooperative launch failed: %s (grid %d)\n", hipGetErrorString(e), grid);
#else
    for (int k = 0; k < N_PHASES; ++k) { p.ph_lo = k; p.ph_hi = k + 1; hipLaunchKernelGGL(trunk_fwd, dim3(grid), dim3(512), LDS_BYTES, stream, p); }
#endif
}
```
